# Optimizing an MI355X kernel written in HIP

```python
import jax, jax.numpy as jnp
from jax import lax
import numpy as np

D_MODEL = 1024
BATCH = 16
SEQ = 4096
DEPTH = 1
DEC_BATCH = 2
DEC_SEQ = 16384
PAST_LEN = 128

GRID_W = 64
N_HEADS = 8
N_KV_HEADS = 2
HEAD_DIM = 64
GROUP = N_HEADS // N_KV_HEADS
ATTN_W = N_HEADS * HEAD_DIM
KV_W = N_KV_HEADS * HEAD_DIM
ROPE_THETA = 10000.0
AXIS_ROT = HEAD_DIM // 2
Q_BLOCK = 128
FOURIER_GROUPS = 4
FOURIER_GROUP_W = 128
FOURIER_W = FOURIER_GROUPS * FOURIER_GROUP_W
P_IN = ATTN_W + 2 * KV_W + FOURIER_W + 2 * D_MODEL
MEM_TOKENS = 256
MEM_HEADS = 4
MEM_HEAD_DIM = D_MODEL // MEM_HEADS
MEM_W = MEM_HEADS * MEM_HEAD_DIM
D_FF = 4 * D_MODEL
ALPHA = (2 * DEPTH) ** 0.25
BETA = (8 * DEPTH) ** -0.25
RMS_EPS = 1e-6
LN_EPS = 1e-5

kernel_name = "gated_parallel_gqa_fourier_encoder"


def _layernorm(x, g, b):
    xf = x.astype(jnp.float32)
    mu = jnp.mean(xf, axis=-1, keepdims=True)
    var = jnp.mean(jnp.square(xf - mu), axis=-1, keepdims=True)
    y = (xf - mu) * lax.rsqrt(var + LN_EPS) * g.astype(jnp.float32) + b.astype(jnp.float32)
    return y.astype(x.dtype)


def _axial_rope_tables(seq_len):
    rows = seq_len // GRID_W
    row = jnp.repeat(jnp.arange(rows, dtype=jnp.float32), GRID_W)
    col = jnp.tile(jnp.arange(GRID_W, dtype=jnp.float32), rows)
    freqs = ROPE_THETA ** (-jnp.arange(0, AXIS_ROT, 2, dtype=jnp.float32) / AXIS_ROT)
    ang = jnp.concatenate([row[:, None] * freqs, col[:, None] * freqs], axis=-1)
    ang = jnp.concatenate([ang, ang], axis=-1)
    return jnp.cos(ang), jnp.sin(ang)


def _qk_prep(x, g, cos, sin):
    xf = x.astype(jnp.float32)
    xf = xf * lax.rsqrt(jnp.mean(jnp.square(xf), axis=-1, keepdims=True) + RMS_EPS) * g.astype(jnp.float32)
    half = HEAD_DIM // 2
    rot = jnp.concatenate([-xf[..., half:], xf[..., :half]], axis=-1)
    y = xf * cos[:, None, :] + rot * sin[:, None, :]
    return y.astype(x.dtype)


def _gqa_blocks(q, k, v):
    bsz, seq_len = q.shape[0], q.shape[1]
    n_blk = seq_len // Q_BLOCK
    qb = q.reshape(bsz, n_blk, Q_BLOCK, N_KV_HEADS, GROUP, HEAD_DIM).transpose(1, 0, 2, 3, 4, 5)
    scale = HEAD_DIM ** -0.5

    def one_block(q_blk):
        s = jnp.einsum('bqkgd,bskd->bkgqs', q_blk, k).astype(jnp.float32) * scale
        p = jax.nn.softmax(s, axis=-1).astype(v.dtype)
        return jnp.einsum('bkgqs,bskd->bqkgd', p, v)

    o = lax.map(one_block, qb)
    return o.transpose(1, 0, 2, 3, 4, 5).reshape(bsz, seq_len, ATTN_W)


def _fourier_mix(u):
    bsz, seq_len = u.shape[0], u.shape[1]
    ug = u.reshape(bsz, seq_len, FOURIER_GROUPS, FOURIER_GROUP_W).astype(jnp.float32)
    f = jnp.fft.fft2(ug, axes=(1, 3), norm='ortho').real
    return f.reshape(bsz, seq_len, FOURIER_W).astype(u.dtype)


def _token_mixer(x, w_in, q_norm, k_norm, w_attn_branch, w_fourier_branch, w_mix_out):
    bsz, seq_len, _ = x.shape
    h = x @ w_in
    o1 = ATTN_W
    o2 = o1 + KV_W
    o3 = o2 + KV_W
    o4 = o3 + FOURIER_W
    o5 = o4 + D_MODEL
    q = h[..., :o1].reshape(bsz, seq_len, N_HEADS, HEAD_DIM)
    k = h[..., o1:o2].reshape(bsz, seq_len, N_KV_HEADS, HEAD_DIM)
    v = h[..., o2:o3].reshape(bsz, seq_len, N_KV_HEADS, HEAD_DIM)
    u = h[..., o3:o4]
    gate_attn = h[..., o4:o5]
    gate_fourier = h[..., o5:]
    cos, sin = _axial_rope_tables(seq_len)
    q = _qk_prep(q, q_norm, cos, sin)
    k = _qk_prep(k, k_norm, cos, sin)
    y_attn = _gqa_blocks(q, k, v) @ w_attn_branch
    y_fourier = _fourier_mix(u) @ w_fourier_branch
    merged = jax.nn.sigmoid(gate_attn) * y_attn + jax.nn.sigmoid(gate_fourier) * y_fourier
    return merged @ w_mix_out


def _memory_xattn(x, mem, w_mem_q, w_mem_k, w_mem_v, w_mem_o):
    bsz, seq_len, _ = x.shape
    q = (x @ w_mem_q).reshape(bsz, seq_len, MEM_HEADS, MEM_HEAD_DIM)
    k = (mem @ w_mem_k).reshape(bsz, MEM_TOKENS, MEM_HEADS, MEM_HEAD_DIM)
    v = (mem @ w_mem_v).reshape(bsz, MEM_TOKENS, MEM_HEADS, MEM_HEAD_DIM)
    s = jnp.einsum('bqhd,bmhd->bhqm', q, k).astype(jnp.float32) * (MEM_HEAD_DIM ** -0.5)
    p = jax.nn.softmax(s, axis=-1).astype(v.dtype)
    o = jnp.einsum('bhqm,bmhd->bqhd', p, v).reshape(bsz, seq_len, MEM_W)
    return o @ w_mem_o


def _sqrelu_mlp(x, w_up, w_down):
    return jnp.square(jax.nn.relu(x @ w_up)) @ w_down


def _layer(x, mem, w_in, q_norm, k_norm, w_attn_branch, w_fourier_branch, w_mix_out,
           ln1_g, ln1_b, w_mem_q, w_mem_k, w_mem_v, w_mem_o, ln2_g, ln2_b,
           w_up, w_down, ln3_g, ln3_b):
    x = _layernorm(ALPHA * x + _token_mixer(x, w_in, q_norm, k_norm, w_attn_branch,
                                            w_fourier_branch, w_mix_out), ln1_g, ln1_b)
    x = _layernorm(ALPHA * x + _memory_xattn(x, mem, w_mem_q, w_mem_k, w_mem_v, w_mem_o), ln2_g, ln2_b)
    x = _layernorm(ALPHA * x + _sqrelu_mlp(x, w_up, w_down), ln3_g, ln3_b)
    return x


def setup_inputs(seed: int = 0) -> dict:
    key = jax.random.key(seed)
    ks = jax.random.split(key, 24)
    f32 = jnp.float32

    def nrm(k, shape, scale):
        return jax.random.normal(k, shape, f32) * scale

    def gain(k):
        return 1.0 + 0.02 * jax.random.normal(k, (DEPTH, D_MODEL), f32)

    def bias(k):
        return 0.02 * jax.random.normal(k, (DEPTH, D_MODEL), f32)

    return {
        "x_prompt": nrm(ks[0], (BATCH, SEQ, D_MODEL), 1.0),
        "x_sample": nrm(ks[1], (DEC_BATCH, DEC_SEQ, D_MODEL), 1.0),
        "mem_prompt": nrm(ks[2], (BATCH, MEM_TOKENS, D_MODEL), 1.0),
        "mem_sample": nrm(ks[3], (DEC_BATCH, MEM_TOKENS, D_MODEL), 1.0),
        "w_in": nrm(ks[4], (DEPTH, D_MODEL, P_IN), D_MODEL ** -0.5),
        "q_norm": 1.0 + 0.02 * jax.random.normal(ks[5], (DEPTH, HEAD_DIM), f32),
        "k_norm": 1.0 + 0.02 * jax.random.normal(ks[6], (DEPTH, HEAD_DIM), f32),
        "w_attn_branch": nrm(ks[7], (DEPTH, ATTN_W, D_MODEL), ATTN_W ** -0.5),
        "w_fourier_branch": nrm(ks[8], (DEPTH, FOURIER_W, D_MODEL), FOURIER_W ** -0.5),
        "w_mix_out": nrm(ks[9], (DEPTH, D_MODEL, D_MODEL), BETA * D_MODEL ** -0.5),
        "ln1_g": gain(ks[10]),
        "ln1_b": bias(ks[11]),
        "w_mem_q": nrm(ks[12], (DEPTH, D_MODEL, MEM_W), D_MODEL ** -0.5),
        "w_mem_k": nrm(ks[13], (DEPTH, D_MODEL, MEM_W), D_MODEL ** -0.5),
        "w_mem_v": nrm(ks[14], (DEPTH, D_MODEL, MEM_W), D_MODEL ** -0.5),
        "w_mem_o": nrm(ks[15], (DEPTH, MEM_W, D_MODEL), BETA * MEM_W ** -0.5),
        "ln2_g": gain(ks[16]),
        "ln2_b": bias(ks[17]),
        "w_up": nrm(ks[18], (DEPTH, D_MODEL, D_FF), D_MODEL ** -0.5),
        "w_down": nrm(ks[19], (DEPTH, D_FF, D_MODEL), BETA * D_FF ** -0.5),
        "ln3_g": gain(ks[20]),
        "ln3_b": bias(ks[21]),
    }


def reference(x_prompt, x_sample, mem_prompt, mem_sample, w_in, q_norm, k_norm,
              w_attn_branch, w_fourier_branch, w_mix_out, ln1_g, ln1_b,
              w_mem_q, w_mem_k, w_mem_v, w_mem_o, ln2_g, ln2_b,
              w_up, w_down, ln3_g, ln3_b):
    y_prompt = x_prompt
    y_sample = x_sample
    for l in range(DEPTH):
        lp = (w_in[l], q_norm[l], k_norm[l], w_attn_branch[l], w_fourier_branch[l], w_mix_out[l],
              ln1_g[l], ln1_b[l], w_mem_q[l], w_mem_k[l], w_mem_v[l], w_mem_o[l],
              ln2_g[l], ln2_b[l], w_up[l], w_down[l], ln3_g[l], ln3_b[l])
        y_prompt = _layer(y_prompt, mem_prompt, *lp)
        y_sample = _layer(y_sample, mem_sample, *lp)
    return (y_prompt, y_sample)
```

```cpp
#include <hip/hip_runtime.h>
#include <hip/hip_cooperative_groups.h>
#include <hip/hip_bf16.h>
#include <cstdio>
#include <cstdint>
#include <cmath>
namespace cg = cooperative_groups;

namespace pg8 {
#define PG8_LAS __attribute__((address_space(3)))
typedef unsigned short bf16_t;
typedef short bf16x8 __attribute__((ext_vector_type(8)));
typedef float f32x4 __attribute__((ext_vector_type(4)));
typedef float f32x2 __attribute__((ext_vector_type(2)));
typedef unsigned u32x4 __attribute__((ext_vector_type(4)));
constexpr int BM = 256, BK = 64, HALF = 128, HTB = HALF * BK * 2  , STAGE_BYTES = 8 * HTB, NXCD = 8, WGM = 8;

__host__ __device__ __forceinline__ int lds_byte(int r, int c) { const int st = (r >> 4) * 2 + (c >> 5), rr = r & 15, cc = c & 31, ob = rr * 64 + cc * 2; return st * 1024 + (ob ^ (((ob >> 9) & 1) << 5)); }
__host__ __device__ __forceinline__ void stage_rc(int b, int& R, int& C) { const int st = b / 1024, sb = b % 1024, swz = sb ^ (((sb >> 9) & 1) << 5); R = (st >> 1) * 16 + swz / 64; C = (st & 1) * 32 + (swz % 64) / 2; }
__host__ __device__ __forceinline__ int perm32(int rho) { const int n = rho >> 4, i = rho & 15; return 8 * (i >> 2) + 4 * n + (i & 3); }

struct Unit { const char* a; const char* b; int pm, pn; };
struct Gemm { int K; unsigned lda_b, ldb_b, hstepA, hstepB; int bm1, bs1, bs2; };
__device__ __forceinline__ Gemm mk_gemm(int K, unsigned lda_b, unsigned ldb_b) { Gemm g; g.K = K; g.lda_b = lda_b; g.ldb_b = ldb_b; g.hstepA = 128u * lda_b; g.hstepB = 128u * ldb_b; g.bm1 = 128; g.bs1 = 1; g.bs2 = 0; return g; }

struct OrderMN {
    int nM, nN, nwg, G, c;
    __device__ __forceinline__ void init(int nM_, int nN_, int G_, int c_) { nM = nM_; nN = nN_; nwg = nM * nN; G = G_; c = c_; }
    __device__ __forceinline__ bool idx(int i, int& pm, int& pn) const {
        const long L = (long)i * G + c; if (L >= nwg) return false;
        int wgid = (int)L; { const int q = nwg / NXCD, r = nwg % NXCD, xcd = wgid % NXCD, off = wgid / NXCD; wgid = (xcd < r ? xcd * (q + 1) : r * (q + 1) + (xcd - r) * q) + off; }
        const int nig = WGM * nN, gid = wgid / nig, fm = gid * WGM, gsz = (nM - fm) < WGM ? (nM - fm) : WGM;
        pm = fm + ((wgid % nig) % gsz); pn = (wgid % nig) / gsz; return true;
    }
};
struct SchedG {
    OrderMN o; const char* A; const char* B; size_t aPm, aInner, bPm, bOuter, bInner, bBatch; int div;
    __device__ __forceinline__ bool next(int i, Unit& u) const {
        if (!o.idx(i, u.pm, u.pn)) return false;
        const int po = u.pn / div, pi = u.pn % div;
        const int bmem = u.pm < 256 ? (u.pm >> 4) : 16 + ((u.pm - 256) >> 6);
        u.a = A + (size_t)u.pm * aPm + (size_t)pi * aInner;
        u.b = B + (size_t)u.pm * bPm + (size_t)po * bOuter + (size_t)pi * bInner + (size_t)bmem * bBatch;
        return true;
    }
};
__device__ __forceinline__ SchedG sched_std(const void* A, unsigned lda_b, int nM, const void* B, unsigned ldb_b, int nN, int G, int c) {
    SchedG s; s.o.init(nM, nN, G, c); s.A = (const char*)A; s.B = (const char*)B; s.aPm = (size_t)256 * lda_b; s.aInner = 0; s.bPm = 0; s.bOuter = 0; s.bInner = (size_t)256 * ldb_b; s.bBatch = 0; s.div = 1 << 30; return s;
}

__device__ __forceinline__ unsigned cvt_pk_bf16(float lo, float hi) { unsigned r; asm volatile("v_cvt_pk_bf16_f32 %0, %1, %2" : "=v"(r) : "v"(lo), "v"(hi)); return r; }
__device__ __forceinline__ u32x4 pack8(const f32x4 v0, const f32x4 v1) { u32x4 w; w.x = cvt_pk_bf16(v0[0], v0[1]); w.y = cvt_pk_bf16(v0[2], v0[3]); w.z = cvt_pk_bf16(v1[0], v1[1]); w.w = cvt_pk_bf16(v1[2], v1[3]); return w; }
__device__ __forceinline__ void unpack8(const u32x4 w, f32x4& v0, f32x4& v1) {
    v0[0] = __uint_as_float(w.x << 16); v0[1] = __uint_as_float(w.x & 0xffff0000u); v0[2] = __uint_as_float(w.y << 16); v0[3] = __uint_as_float(w.y & 0xffff0000u);
    v1[0] = __uint_as_float(w.z << 16); v1[1] = __uint_as_float(w.z & 0xffff0000u); v1[2] = __uint_as_float(w.w << 16); v1[3] = __uint_as_float(w.w & 0xffff0000u); }

template <int ACT> struct EpiBf16 {
    static constexpr bool PERM = true;
    bf16_t* O; int ldc; float scale;
    __device__ __forceinline__ void operator()(const f32x4 (&acc)[2][2][4][2], const Unit& u, int wr, int wc, int fr, int fq, PG8_LAS unsigned char*) const {
        const int row0 = u.pm * BM + wr * 64 + fr, col0 = u.pn * BM + wc * 32 + 8 * fq;
#pragma unroll
        for (int ai = 0; ai < 2; ++ai)
#pragma unroll
            for (int m = 0; m < 4; ++m) { bf16_t* rowp = O + (size_t)(row0 + ai * HALF + m * 16) * ldc + col0;
#pragma unroll
                for (int bj = 0; bj < 2; ++bj) { f32x4 v0 = acc[ai][bj][m][0], v1 = acc[ai][bj][m][1];
                    if (ACT == 2) {
#pragma unroll
                        for (int e = 0; e < 4; ++e) { const float a = fmaxf(v0[e], 0.f), b = fmaxf(v1[e], 0.f); v0[e] = a * a; v1[e] = b * b; } }
                    v0 = v0 * scale; v1 = v1 * scale; *(u32x4*)(rowp + bj * HALF) = pack8(v0, v1); } }
    }
};

struct EpiIn {
    static constexpr bool PERM = true;
    bf16_t *Q, *Kb, *Vb, *GA, *GF; const float* qn; const float* kn; const float* rope;
    __device__ __forceinline__ void operator()(const f32x4 (&acc)[2][2][4][2], const Unit& u, int wr, int wc, int fr, int fq, PG8_LAS unsigned char*) const {
        const int pn = u.pn, row0 = u.pm * BM + wr * 64 + fr, j0 = 8 * fq;
        if (pn >= 3) {
            bf16_t* base = (pn < 7 ? GA : GF) + ((pn - 3) & 3) * 256 + wc * 64 + j0;
#pragma unroll
            for (int ai = 0; ai < 2; ++ai)
#pragma unroll
                for (int m = 0; m < 4; ++m) { bf16_t* rowp = base + (size_t)(row0 + ai * HALF + m * 16) * 1024;
#pragma unroll
                    for (int bj = 0; bj < 2; ++bj) { f32x4 v0 = acc[ai][bj][m][0], v1 = acc[ai][bj][m][1];
#pragma unroll
                        for (int e = 0; e < 4; ++e) { v0[e] = __builtin_amdgcn_rcpf(1.f + __expf(-v0[e])); v1[e] = __builtin_amdgcn_rcpf(1.f + __expf(-v1[e])); }
                        *(u32x4*)(rowp + bj * 32) = pack8(v0, v1); } }
        } else if (pn == 2 && wc >= 2) {
            bf16_t* base = Vb + (wc - 2) * 64 + j0;
#pragma unroll
            for (int ai = 0; ai < 2; ++ai)
#pragma unroll
                for (int m = 0; m < 4; ++m) { bf16_t* rowp = base + (size_t)(row0 + ai * HALF + m * 16) * 128;
#pragma unroll
                    for (int bj = 0; bj < 2; ++bj) *(u32x4*)(rowp + bj * 32) = pack8(acc[ai][bj][m][0], acc[ai][bj][m][1]); }
        } else {
            const bool isq = pn < 2; const float* gn = isq ? qn : kn;
            const float osc = isq ? 0.125f * 1.4426950408889634f : 1.0f;
            bf16_t* base = isq ? Q + (pn * 4 + wc) * 64 + j0 : Kb + wc * 64 + j0; const int pitch = isq ? 512 : 128;
            f32x4 g[2][2];
#pragma unroll
            for (int bj = 0; bj < 2; ++bj)
#pragma unroll
                for (int n = 0; n < 2; ++n) g[bj][n] = *(const f32x4*)(gn + 32 * bj + j0 + 4 * n);
#pragma unroll
            for (int ai = 0; ai < 2; ++ai)
#pragma unroll
                for (int m = 0; m < 4; ++m) {
                    const int row = row0 + ai * HALF + m * 16;
                    float ss = 0.f;
#pragma unroll
                    for (int bj = 0; bj < 2; ++bj)
#pragma unroll
                        for (int n = 0; n < 2; ++n) { const f32x4 x = acc[ai][bj][m][n]; ss += (x[0] * x[0] + x[1] * x[1]) + (x[2] * x[2] + x[3] * x[3]); }
                    ss += __shfl_xor(ss, 16); ss += __shfl_xor(ss, 32);
                    const float rs = 1.0f / sqrtf(ss * (1.0f / 64.0f) + 1e-6f);
                    const int s = row < 65536 ? (row & 4095) : ((row - 65536) & 16383);
                    const int tix = fq < 2 ? (s >> 6) * 16 + j0 : (256 + (s & 63)) * 16 + (j0 - 16);
                    const f32x4* tp = (const f32x4*)(rope + 2 * tix);
                    f32x4 y0[2], y1[2];
#pragma unroll
                    for (int n = 0; n < 2; ++n) { const f32x4 cs0 = tp[2 * n], cs1 = tp[2 * n + 1];
                        const f32x4 x0 = acc[ai][0][m][n] * rs * g[0][n], x1 = acc[ai][1][m][n] * rs * g[1][n];
                        y0[n][0] = (x0[0] * cs0[0] - x1[0] * cs0[1]) * osc; y1[n][0] = (x1[0] * cs0[0] + x0[0] * cs0[1]) * osc;
                        y0[n][1] = (x0[1] * cs0[2] - x1[1] * cs0[3]) * osc; y1[n][1] = (x1[1] * cs0[2] + x0[1] * cs0[3]) * osc;
                        y0[n][2] = (x0[2] * cs1[0] - x1[2] * cs1[1]) * osc; y1[n][2] = (x1[2] * cs1[0] + x0[2] * cs1[1]) * osc;
                        y0[n][3] = (x0[3] * cs1[2] - x1[3] * cs1[3]) * osc; y1[n][3] = (x1[3] * cs1[2] + x0[3] * cs1[3]) * osc; }
                    bf16_t* rowp = base + (size_t)row * pitch;
                    *(u32x4*)(rowp) = pack8(y0[0], y0[1]); *(u32x4*)(rowp + 32) = pack8(y1[0], y1[1]);
                }
        }
    }
};

struct EpiZ {
    static constexpr bool PERM = true;
    bf16_t* Z; int sh, jdiv;
    __device__ __forceinline__ void operator()(const f32x4 (&acc)[2][2][4][2], const Unit& u, int wr, int wc, int fr, int fq, PG8_LAS unsigned char*) const {
        const int b = u.pn / jdiv, j = u.pn % jdiv, p = u.pm >> 1, colb = (u.pm & 1) * 256 + wr * 64 + fr;
        const int r = 32 * wc + 8 * fq, S1m = (1 << sh) - 1;
#pragma unroll
        for (int bj = 0; bj < 2; ++bj) {
            const int s2 = j * (256 >> sh) + bj * (128 >> sh) + (r >> sh), s1 = r & S1m;
#pragma unroll
            for (int ai = 0; ai < 2; ++ai)
#pragma unroll
                for (int m = 0; m < 4; ++m) { const int col = colb + ai * HALF + m * 16;
                    bf16_t* dst = Z + ((((size_t)(b * 512 + col) << sh) + s2) << (sh + 1)) + (p << sh) + s1;
                    *(u32x4*)dst = pack8(acc[ai][bj][m][0], acc[ai][bj][m][1]); } }
    }
};
struct EpiY {
    static constexpr bool PERM = true;
    bf16_t* Y; int sample;
    __device__ __forceinline__ void operator()(const f32x4 (&acc)[2][2][4][2], const Unit& u, int wr, int wc, int fr, int fq, PG8_LAS unsigned char*) const {
#pragma unroll
        for (int bj = 0; bj < 2; ++bj) {
            const int ng = u.pn * BM + bj * HALF + 32 * wc + 8 * fq;
#pragma unroll
            for (int ai = 0; ai < 2; ++ai)
#pragma unroll
                for (int m = 0; m < 4; ++m) { const int rt = ai * HALF + wr * 64 + m * 16 + fr; bf16_t* dst;
                    if (sample) { const int q = rt >> 7, k1 = rt & 127, bcol = ng >> 7, s2 = ng & 127; dst = Y + ((size_t)(bcol * 128 + k1) * 256 + q * 128 + s2); }
                    else { const int s2l = rt >> 7, q = (rt >> 6) & 1, k1 = rt & 63, bcol = ng >> 5, jj = ng & 31; dst = Y + ((size_t)(bcol * 64 + k1) * 128 + q * 64 + s2l * 32 + jj); }
                    *(u32x4*)dst = pack8(acc[ai][bj][m][0], acc[ai][bj][m][1]); } }
    }
};
struct EpiF {
    static constexpr bool PERM = true;
    bf16_t* F; int sample;
    __device__ __forceinline__ void operator()(const f32x4 (&acc)[2][2][4][2], const Unit& u, int wr, int wc, int fr, int fq, PG8_LAS unsigned char*) const {
        const int g = u.pm, b = u.pn >> 1, ct = u.pn & 1, col0 = ct * 256 + 32 * wc + 8 * fq;
#pragma unroll
        for (int ai = 0; ai < 2; ++ai)
#pragma unroll
            for (int m = 0; m < 4; ++m) { const int rt = ai * HALF + wr * 64 + m * 16 + fr; size_t tok;
                if (sample) tok = (size_t)65536 + b * 16384 + (2 * g + (rt >> 7)) + 128 * (rt & 127);
                else tok = (size_t)b * 4096 + (4 * g + (rt >> 6)) + 64 * (rt & 63);
                bf16_t* rowp = F + tok * 512 + col0;
#pragma unroll
                for (int bj = 0; bj < 2; ++bj) *(u32x4*)(rowp + bj * HALF) = pack8(acc[ai][bj][m][0], acc[ai][bj][m][1]); }
    }
};
template <int MODE> struct EpiGate {
    static constexpr bool PERM = true;
    bf16_t* GA; const bf16_t* GF;
    __device__ __forceinline__ void operator()(const f32x4 (&acc)[2][2][4][2], const Unit& u, int wr, int wc, int fr, int fq, PG8_LAS unsigned char*) const {
        const int row0 = u.pm * BM + wr * 64 + fr, col0 = u.pn * BM + wc * 32 + 8 * fq;
#pragma unroll
        for (int ai = 0; ai < 2; ++ai)
#pragma unroll
            for (int m = 0; m < 4; ++m) { const size_t off = (size_t)(row0 + ai * HALF + m * 16) * 1024 + col0;
#pragma unroll
                for (int bj = 0; bj < 2; ++bj) { f32x4 a0, a1; unpack8(*(const u32x4*)(GA + off + bj * HALF), a0, a1);
                    if (MODE == 0) { a0 = a0 * acc[ai][bj][m][0]; a1 = a1 * acc[ai][bj][m][1]; }
                    else { f32x4 f0, f1; unpack8(*(const u32x4*)(GF + off + bj * HALF), f0, f1); a0 = a0 + f0 * acc[ai][bj][m][0]; a1 = a1 + f1 * acc[ai][bj][m][1]; }
                    *(u32x4*)(GA + off + bj * HALF) = pack8(a0, a1); } }
    }
};
struct EpiRes {
    static constexpr bool PERM = false;
    const float* s0; const float* s1; float* out; float alpha;
    __device__ __forceinline__ void operator()(const f32x4 (&acc)[2][2][4][2], const Unit& u, int wr, int wc, int fr, int fq, PG8_LAS unsigned char*) const {
        const int row0 = u.pm * BM + wr * 64 + fr, col0 = u.pn * BM + wc * 32 + 4 * fq;
        const float* src = (u.pm < 256) ? s0 : s1;
#pragma unroll
        for (int ai = 0; ai < 2; ++ai)
#pragma unroll
            for (int m = 0; m < 4; ++m) { const size_t off = (size_t)(row0 + ai * HALF + m * 16) * 1024 + col0;
#pragma unroll
                for (int bj = 0; bj < 2; ++bj)
#pragma unroll
                    for (int n = 0; n < 2; ++n) { const f32x4 bs = *(const f32x4*)(src + off + bj * HALF + n * 16); *(f32x4*)(out + off + bj * HALF + n * 16) = bs * alpha + acc[ai][bj][m][n]; } }
    }
};
struct EpiSoftmax {
    static constexpr bool PERM = true;
    bf16_t* P;
    __device__ __forceinline__ void operator()(f32x4 (&acc)[2][2][4][2], const Unit& u, int wr, int wc, int fr, int fq, PG8_LAS unsigned char* xl) const {
        PG8_LAS float* smax = (PG8_LAS float*)xl; PG8_LAS float* ssum = (PG8_LAS float*)(xl + 4096);
#pragma unroll
        for (int ai = 0; ai < 2; ++ai)
#pragma unroll
            for (int m = 0; m < 4; ++m) { float mx = -INFINITY;
#pragma unroll
                for (int bj = 0; bj < 2; ++bj)
#pragma unroll
                    for (int n = 0; n < 2; ++n) { const f32x4 x = acc[ai][bj][m][n]; mx = fmaxf(mx, fmaxf(fmaxf(x[0], x[1]), fmaxf(x[2], x[3]))); }
                mx = fmaxf(mx, __shfl_xor(mx, 16)); mx = fmaxf(mx, __shfl_xor(mx, 32));
                if (fq == 0) smax[(ai * HALF + wr * 64 + m * 16 + fr) * 4 + wc] = mx; }
        asm volatile("s_waitcnt lgkmcnt(0)" ::: "memory"); __builtin_amdgcn_s_barrier(); asm volatile("" ::: "memory");
#pragma unroll
        for (int ai = 0; ai < 2; ++ai)
#pragma unroll
            for (int m = 0; m < 4; ++m) { const int r = ai * HALF + wr * 64 + m * 16 + fr; const f32x4 mm = *(const PG8_LAS f32x4*)(smax + r * 4);
                const float mx = fmaxf(fmaxf(mm[0], mm[1]), fmaxf(mm[2], mm[3])); float s = 0.f;
#pragma unroll
                for (int bj = 0; bj < 2; ++bj)
#pragma unroll
                    for (int n = 0; n < 2; ++n) { f32x4 x = acc[ai][bj][m][n];
#pragma unroll
                        for (int e = 0; e < 4; ++e) x[e] = __builtin_amdgcn_exp2f(x[e] - mx);
                        acc[ai][bj][m][n] = x; s += (x[0] + x[1]) + (x[2] + x[3]); }
                s += __shfl_xor(s, 16); s += __shfl_xor(s, 32);
                if (fq == 0) ssum[r * 4 + wc] = s; }
        asm volatile("s_waitcnt lgkmcnt(0)" ::: "memory"); __builtin_amdgcn_s_barrier(); asm volatile("" ::: "memory");
        const int row0 = u.pm * BM + wr * 64 + fr, col0 = u.pn * BM + wc * 32 + 8 * fq;
#pragma unroll
        for (int ai = 0; ai < 2; ++ai)
#pragma unroll
            for (int m = 0; m < 4; ++m) { const int r = ai * HALF + wr * 64 + m * 16 + fr; const f32x4 sv = *(const PG8_LAS f32x4*)(ssum + r * 4);
                const float inv = 1.0f / ((sv[0] + sv[1]) + (sv[2] + sv[3]));
                bf16_t* rowp = P + (size_t)(row0 + ai * HALF + m * 16) * 1024 + col0;
#pragma unroll
                for (int bj = 0; bj < 2; ++bj) *(u32x4*)(rowp + bj * HALF) = pack8(acc[ai][bj][m][0] * inv, acc[ai][bj][m][1] * inv); }
    }
};

template <class Epi, class Sched, bool ALIGN_EPI = false, bool SP2 = false>
__device__ __forceinline__ void gemm_phase(PG8_LAS unsigned char* lds, PG8_LAS unsigned char* xl, const Gemm g, const Sched& S, const Epi& E) {
    const int tid = threadIdx.x, wid = __builtin_amdgcn_readfirstlane(tid >> 6), lane = tid & 63, wr = wid >> 2, wc = wid & 3, fr = lane & 15, fq = lane >> 4;
    const int K = g.K, nt = K / BK;
    unsigned voffA[2], voffB[2];
#pragma unroll
    for (int i = 0; i < 2; ++i) { int R, C; stage_rc(tid * 16 + i * 8192, R, C); const int Rb = Epi::PERM ? ((R & ~31) + perm32(R & 31)) : R;
        voffA[i] = (unsigned)R * g.lda_b + (unsigned)C * 2u; voffB[i] = (unsigned)((Rb % g.bm1) * g.bs1 + (Rb / g.bm1) * g.bs2) * g.ldb_b + (unsigned)C * 2u; }
    const size_t kstep = (size_t)(BK * 2);
    const size_t hstepA = g.hstepA, hstepB = g.hstepB;
    const unsigned ldsw = (unsigned)wid * 1024u;
    const int aoff = lds_byte(wr * 64 + fr, fq * 8), boff = lds_byte(wc * 32 + fr, fq * 8);
#define PG8_SA(b, h) (((b) * 2 + (h)) * HTB)
#define PG8_SB(b, h) ((4 + (b) * 2 + (h)) * HTB)
#define PG8_STAGE(bufoff, gbase, voff) do { _Pragma("unroll") for (int _i = 0; _i < 2; ++_i) \
        __builtin_amdgcn_global_load_lds((const unsigned*)((const char*)(gbase) + (voff)[_i]), (PG8_LAS unsigned*)(lds + (bufoff) + ldsw + _i * 8192), 16, 0, 0); } while (0)
#define PG8_LDA(dst, b, h) do { _Pragma("unroll") for (int m = 0; m < 4; ++m) _Pragma("unroll") for (int k = 0; k < 2; ++k) dst[m][k] = *(const PG8_LAS bf16x8*)(lds + PG8_SA(b, h) + aoff + m * 2048 + k * 1024); } while (0)
#define PG8_LDB(dst, b, h) do { _Pragma("unroll") for (int n = 0; n < 2; ++n) _Pragma("unroll") for (int k = 0; k < 2; ++k) dst[n][k] = *(const PG8_LAS bf16x8*)(lds + PG8_SB(b, h) + boff + n * 2048 + k * 1024); } while (0)
#define PG8_MMA(ai, bj, At, Bt) do { __builtin_amdgcn_s_setprio(1); _Pragma("unroll") for (int m = 0; m < 4; ++m) _Pragma("unroll") for (int n = 0; n < 2; ++n) _Pragma("unroll") for (int k = 0; k < 2; ++k) \
        acc[ai][bj][m][n] = __builtin_amdgcn_mfma_f32_16x16x32_bf16(Bt[n][k], At[m][k], acc[ai][bj][m][n], 0, 0, 0); __builtin_amdgcn_s_setprio(0); } while (0)
#define PG8_WAIT_V(n) asm volatile("s_waitcnt vmcnt(" #n ")" ::: "memory")
#define PG8_WAIT_L(n) asm volatile("s_waitcnt lgkmcnt(" #n ")" ::: "memory")
#define PG8_BAR __builtin_amdgcn_s_barrier()
#define PG8_SCHED __builtin_amdgcn_sched_barrier(0)
    Unit cur, nxt; int ui = 0;
    if (!S.next(0, cur)) return;
    f32x4 acc[2][2][4][2];
#pragma unroll
    for (int a = 0; a < 2; ++a)
#pragma unroll
        for (int b = 0; b < 2; ++b)
#pragma unroll
            for (int m = 0; m < 4; ++m)
#pragma unroll
                for (int n = 0; n < 2; ++n) acc[a][b][m][n] = (f32x4){0.f, 0.f, 0.f, 0.f};
    bf16x8 At[4][2], B0[2][2], B1[2][2];
    const char* cA = cur.a; const char* cB = cur.b;
    if constexpr (SP2) {
        PG8_STAGE(PG8_SB(0, 0), cB, voffB); PG8_STAGE(PG8_SB(0, 1), cB + hstepB, voffB); PG8_STAGE(PG8_SA(0, 0), cA, voffA); PG8_STAGE(PG8_SA(0, 1), cA + hstepA, voffA);
        if (wr == 1) PG8_BAR;
        PG8_WAIT_V(2); PG8_BAR;
        PG8_STAGE(PG8_SB(1, 0), cB + kstep, voffB); PG8_STAGE(PG8_SA(1, 0), cA + kstep, voffA); PG8_STAGE(PG8_SB(1, 1), cB + hstepB + kstep, voffB);
        PG8_WAIT_V(6); PG8_BAR;
    } else {
        PG8_STAGE(PG8_SB(0, 0), cB, voffB); PG8_STAGE(PG8_SA(0, 0), cA, voffA); PG8_STAGE(PG8_SB(0, 1), cB + hstepB, voffB); PG8_STAGE(PG8_SA(0, 1), cA + hstepA, voffA);
        if (wr == 1) PG8_BAR;
        PG8_WAIT_V(4); PG8_BAR;
        PG8_STAGE(PG8_SB(1, 0), cB + kstep, voffB); PG8_STAGE(PG8_SA(1, 0), cA + kstep, voffA); PG8_STAGE(PG8_SB(1, 1), cB + hstepB + kstep, voffB);
        PG8_WAIT_V(6); PG8_BAR;
    }
    for (;;) {
        const bool has_next = S.next(ui + 1, nxt);
        const char* nA = has_next ? nxt.a : cA; const char* nB = has_next ? nxt.b : cB;
        for (int t = 0; t < nt; t += 2) {
            const bool last = (t == nt - 2);
            const char* a1 = cA + (size_t)(t + 1) * kstep;
            const char* a2 = last ? nA : cA + (size_t)(t + 2) * kstep; const char* b2 = last ? nB : cB + (size_t)(t + 2) * kstep;
            const char* a3 = a2 + kstep; const char* b3 = b2 + kstep;
            if constexpr (SP2) {
            PG8_LDB(B0, 0, 0); PG8_LDB(B1, 0, 1); PG8_SCHED; PG8_LDA(At, 0, 0); PG8_STAGE(PG8_SA(1, 1), a1 + hstepA, voffA);
            PG8_WAIT_V(8); PG8_WAIT_L(0); PG8_BAR; PG8_MMA(0, 0, At, B0); PG8_MMA(0, 1, At, B1); PG8_BAR; PG8_SCHED;
            PG8_LDA(At, 0, 1); PG8_STAGE(PG8_SB(0, 0), b2, voffB); PG8_STAGE(PG8_SB(0, 1), b2 + hstepB, voffB); PG8_STAGE(PG8_SA(0, 0), a2, voffA);
            PG8_WAIT_V(8); PG8_WAIT_L(0); PG8_BAR; PG8_MMA(1, 0, At, B0); PG8_MMA(1, 1, At, B1); PG8_BAR; PG8_SCHED;
            PG8_LDB(B0, 1, 0); PG8_LDB(B1, 1, 1); PG8_SCHED; PG8_LDA(At, 1, 0); PG8_STAGE(PG8_SA(0, 1), a2 + hstepA, voffA);
            PG8_WAIT_V(8); PG8_WAIT_L(0); PG8_BAR; PG8_MMA(0, 0, At, B0); PG8_MMA(0, 1, At, B1); PG8_BAR; PG8_SCHED;
            PG8_LDA(At, 1, 1); PG8_STAGE(PG8_SB(1, 0), b3, voffB); PG8_STAGE(PG8_SB(1, 1), b3 + hstepB, voffB); PG8_STAGE(PG8_SA(1, 0), a3, voffA);
            PG8_WAIT_V(8); PG8_WAIT_L(0); PG8_BAR; PG8_MMA(1, 0, At, B0); PG8_MMA(1, 1, At, B1); PG8_BAR; PG8_SCHED;
            } else {
            PG8_LDB(B0, 0, 0); PG8_SCHED; PG8_LDA(At, 0, 0); PG8_STAGE(PG8_SA(1, 1), a1 + hstepA, voffA);
            PG8_WAIT_L(8); PG8_BAR; PG8_WAIT_L(0); PG8_MMA(0, 0, At, B0); PG8_BAR; PG8_SCHED;
            PG8_LDB(B1, 0, 1); PG8_STAGE(PG8_SB(0, 0), b2, voffB);
            PG8_BAR; PG8_WAIT_L(0); PG8_MMA(0, 1, At, B1); PG8_BAR;
            PG8_LDA(At, 0, 1); PG8_STAGE(PG8_SA(0, 0), a2, voffA);
            PG8_BAR; PG8_WAIT_L(0); PG8_MMA(1, 0, At, B0); PG8_BAR; PG8_SCHED;
            PG8_STAGE(PG8_SB(0, 1), b2 + hstepB, voffB);
            PG8_WAIT_V(6); PG8_BAR; PG8_MMA(1, 1, At, B1); PG8_BAR;
            PG8_LDB(B0, 1, 0); PG8_SCHED; PG8_LDA(At, 1, 0); PG8_STAGE(PG8_SA(0, 1), a2 + hstepA, voffA);
            PG8_WAIT_L(8); PG8_BAR; PG8_WAIT_L(0); PG8_MMA(0, 0, At, B0); PG8_BAR; PG8_SCHED;
            PG8_LDB(B1, 1, 1); PG8_STAGE(PG8_SB(1, 0), b3, voffB);
            PG8_BAR; PG8_WAIT_L(0); PG8_MMA(0, 1, At, B1); PG8_BAR;
            PG8_LDA(At, 1, 1); PG8_STAGE(PG8_SA(1, 0), a3, voffA);
            PG8_BAR; PG8_WAIT_L(0); PG8_MMA(1, 0, At, B0); PG8_BAR; PG8_SCHED;
            PG8_STAGE(PG8_SB(1, 1), b3 + hstepB, voffB);
            PG8_WAIT_V(6); PG8_BAR; PG8_MMA(1, 1, At, B1); PG8_BAR;
            }
        }
        if constexpr (ALIGN_EPI) { if (wr == 0) PG8_BAR; }
        E(acc, cur, wr, wc, fr, fq, xl);
        if (!has_next) break;
#pragma unroll
        for (int a = 0; a < 2; ++a)
#pragma unroll
            for (int b = 0; b < 2; ++b)
#pragma unroll
                for (int m = 0; m < 4; ++m)
#pragma unroll
                    for (int n = 0; n < 2; ++n) acc[a][b][m][n] = (f32x4){0.f, 0.f, 0.f, 0.f};
        cur = nxt; cA = nA; cB = nB; ++ui;
        if constexpr (ALIGN_EPI) { if (wr == 1) PG8_BAR; }
    }
    PG8_WAIT_V(0);
    if constexpr (!ALIGN_EPI) { if (wr == 0) PG8_BAR; }
    PG8_BAR;
#undef PG8_SA
#undef PG8_SB
#undef PG8_STAGE
#undef PG8_LDA
#undef PG8_LDB
#undef PG8_MMA
#undef PG8_WAIT_V
#undef PG8_WAIT_L
#undef PG8_BAR
#undef PG8_SCHED
}
}

#include <hip/hip_bf16.h>
#include <cmath>
namespace attn_body {
using bf16=__hip_bfloat16;
using bf16x8=__attribute__((ext_vector_type(8)))short;
using s16x4=__attribute__((ext_vector_type(4)))short;
using f32x16=__attribute__((ext_vector_type(16)))float;
using u32x4=__attribute__((ext_vector_type(4)))unsigned;
constexpr int D=64,QP=512,KP=128;
constexpr int NW=8,QBLK=32,QB=QBLK*NW,KVBLK=64;
constexpr int ATTN_UNIT_ROWS=QB;
__device__ __forceinline__ int crow(int r,int hi){return (r&3)+8*(r>>2)+4*hi;}
#define SBAR() __builtin_amdgcn_sched_barrier(0)
__device__ __forceinline__ void cmask(f32x16&p0,f32x16&p1,int jb,int qrel,int hi){
  const float NEG=-INFINITY; int kb=64*jb+4*hi;
  #pragma unroll
  for(int r=0;r<16;++r){int kv=kb+(r&3)+8*(r>>2); if(kv>qrel)p0[r]=NEG; if(kv+32>qrel)p1[r]=NEG;}
}

constexpr int NSLOT=3, SLOTB=8192;
constexpr int LDS_K=0, LDS_V=NSLOT*SLOTB, LDS_WS=2*NSLOT*SLOTB, LDS_OST=LDS_WS+NW*64*4, LDS_BYTES=LDS_OST+NW*4096;
constexpr float C2=0.125f*1.4426950408889634f;
__device__ __forceinline__ void glds16(const void*gsrc,unsigned lds_dst){unsigned keep;
  asm volatile("s_mov_b32 %0, m0\n\ts_mov_b32 m0, %2\n\ts_nop 0\n\tglobal_load_lds_dwordx4 %1, off\n\ts_mov_b32 m0, %0":"=&s"(keep):"v"(gsrc),"s"(lds_dst):"memory");}
__device__ __forceinline__ float max3f(float a,float b,float c){float r;asm("v_max3_f32 %0, %1, %2, %3":"=v"(r):"v"(a),"v"(b),"v"(c));return r;}
__device__ __forceinline__ float max2f(float a,float b){float r;asm("v_max_f32_e32 %0, %1, %2":"=v"(r):"v"(a),"v"(b));return r;}
__device__ __forceinline__ float fadd_s(float a,float b){float r;asm("v_add_f32_e32 %0, %1, %2":"=v"(r):"v"(a),"v"(b));return r;}
__device__ __forceinline__ float fsub_s(float a,float b){float r;asm("v_sub_f32_e32 %0, %1, %2":"=v"(r):"v"(a),"v"(b));return r;}
typedef float f32x2_t __attribute__((ext_vector_type(2))); typedef __bf16 bf16x2_t __attribute__((ext_vector_type(2)));
__device__ __forceinline__ unsigned cvtpk_s(float lo,float hi){f32x2_t v={lo,hi};bf16x2_t b=__builtin_convertvector(v,bf16x2_t);return __builtin_bit_cast(unsigned,b);}
#define WAIT_BAR(N) asm volatile("s_waitcnt vmcnt(" #N ") lgkmcnt(0)\n\ts_barrier":::"memory")

__device__ __forceinline__ void qkt(f32x16&p0,f32x16&p1,const char*Kslot,const bf16x8*qr,const f32x16&negm,int r32,int hi){
  const char*kb=Kslot+hi*1024+r32*16;
  #pragma unroll
  for(int d0=0;d0<4;++d0){
    const bf16x8 b0=*reinterpret_cast<const bf16x8*>(kb+d0*2048);
    const bf16x8 b1=*reinterpret_cast<const bf16x8*>(kb+d0*2048+512);
    if(d0==0){p0=__builtin_amdgcn_mfma_f32_32x32x16_bf16(b0,qr[0],negm,0,0,0);p1=__builtin_amdgcn_mfma_f32_32x32x16_bf16(b1,qr[0],negm,0,0,0);}
    else{p0=__builtin_amdgcn_mfma_f32_32x32x16_bf16(b0,qr[d0],p0,0,0,0);p1=__builtin_amdgcn_mfma_f32_32x32x16_bf16(b1,qr[d0],p1,0,0,0);}}
}
typedef __attribute__((address_space(3))) const char* lds_cptr;
typedef short v4i16_t __attribute__((ext_vector_type(4)));
__device__ __forceinline__ void kload8(bf16x8*kf,lds_cptr kp){
  kf[0]=*(const __attribute__((address_space(3))) bf16x8*)(kp);      kf[1]=*(const __attribute__((address_space(3))) bf16x8*)(kp+512);
  kf[2]=*(const __attribute__((address_space(3))) bf16x8*)(kp+2048); kf[3]=*(const __attribute__((address_space(3))) bf16x8*)(kp+2560);
  kf[4]=*(const __attribute__((address_space(3))) bf16x8*)(kp+4096); kf[5]=*(const __attribute__((address_space(3))) bf16x8*)(kp+4608);
  kf[6]=*(const __attribute__((address_space(3))) bf16x8*)(kp+6144); kf[7]=*(const __attribute__((address_space(3))) bf16x8*)(kp+6656);
}
__device__ __forceinline__ void kload2(bf16x8*kf,lds_cptr kp,int j){ kf[2*j]=*(const __attribute__((address_space(3))) bf16x8*)(kp+j*2048); kf[2*j+1]=*(const __attribute__((address_space(3))) bf16x8*)(kp+j*2048+512); }
__device__ __forceinline__ s16x4 vtr(lds_cptr p){ return __builtin_bit_cast(s16x4,__builtin_amdgcn_ds_read_tr16_b64_v4i16((__attribute__((address_space(3))) v4i16_t*)p)); }
__device__ __forceinline__ float rowmax(const f32x16&p0,const f32x16&p1){
  float a=max3f(p0[0],p0[1],p1[0]),b=max3f(p0[2],p0[3],p1[1]);a=max3f(a,p1[2],p1[3]);
  #pragma unroll
  for(int r=4;r<16;r+=4){a=max3f(a,p0[r],p0[r+1]);b=max3f(b,p0[r+2],p0[r+3]);a=max3f(a,p1[r],p1[r+1]);b=max3f(b,p1[r+2],p1[r+3]);}
  const float m=max2f(a,b);
  auto rr=__builtin_amdgcn_permlane32_swap(__float_as_uint(m),__float_as_uint(m),false,false);
  return max2f(__uint_as_float(rr[0]),__uint_as_float(rr[1]));
}
__device__ __forceinline__ void pv(f32x16*o,int vb,bf16x8 pa0,bf16x8 pa1,bf16x8 pa2,bf16x8 pa3){
  #pragma unroll
  for(int d0=0;d0<2;++d0){s16x4 lo[4],hi[4];
    #pragma unroll
    for(int ks=0;ks<4;++ks){
      asm volatile("ds_read_b64_tr_b16 %0,%1 offset:%c2":"=&v"(lo[ks]):"v"(vb),"i"(d0*4096+ks*1024):"memory");
      asm volatile("ds_read_b64_tr_b16 %0,%1 offset:%c2":"=&v"(hi[ks]):"v"(vb),"i"(d0*4096+ks*1024+512):"memory");}
    asm volatile("s_waitcnt lgkmcnt(0)":::"memory");SBAR();
    #define PK(k) (bf16x8){lo[k][0],lo[k][1],lo[k][2],lo[k][3],hi[k][0],hi[k][1],hi[k][2],hi[k][3]}
    o[d0]=__builtin_amdgcn_mfma_f32_32x32x16_bf16(pa0,PK(0),o[d0],0,0,0);
    o[d0]=__builtin_amdgcn_mfma_f32_32x32x16_bf16(pa1,PK(1),o[d0],0,0,0);
    o[d0]=__builtin_amdgcn_mfma_f32_32x32x16_bf16(pa2,PK(2),o[d0],0,0,0);
    o[d0]=__builtin_amdgcn_mfma_f32_32x32x16_bf16(pa3,PK(3),o[d0],0,0,0);
    #undef PK
  }
}

#ifndef ATTN_STORE16
#define ATTN_STORE16(p,v) (*(u32x4*)(p)=(v))
#endif
template<int THRL> __device__ __forceinline__ void attn_unit(long rowbase,int h,int qb,int NT,const bf16*Q,const bf16*__restrict__ K,const bf16*__restrict__ V,bf16*O,char*shm){
  const int tid=threadIdx.x,lane=tid&63,r32=lane&31,hi=lane>>5; const int wid=__builtin_amdgcn_readfirstlane(tid>>6);
  const int q0=qb*QB;
  const bf16*Qw=Q+(rowbase+q0+wid*QBLK)*QP+h*D;
  const bf16*Kh=K+rowbase*KP+(h>>2)*D,*Vh=V+rowbase*KP+(h>>2)*D;
  const unsigned lds0=(unsigned)(uintptr_t)shm;
  float*wsf=(float*)(shm+LDS_WS)+wid*64;
  const bf16*ksrc=Kh+(long)lane*KP+wid*8;
  const bf16*vsrc=Vh+(long)(16*(wid&3)+(lane>>2))*KP+(wid>>2)*32+(lane&3)*8;
  const unsigned kdst=lds0+LDS_K+wid*1024, vdst=lds0+LDS_V+wid*1024;
  #define DMA_K(t,slot) glds16(ksrc+(long)(t)*KVBLK*KP,(unsigned)__builtin_amdgcn_readfirstlane(kdst+(slot)))
  #define DMA_V(t,slot) glds16(vsrc+(long)(t)*KVBLK*KP,(unsigned)__builtin_amdgcn_readfirstlane(vdst+(slot)))
  const int vb0=(int)(lds0+LDS_V)+((lane>>4)&1)*32+(lane&3)*8+(4*hi+((lane&15)>>2))*64;
  const char*Kbase=shm+LDS_K; bf16x8 kf[8];
  const lds_cptr shm3=(lds_cptr)shm; const lds_cptr kp0=shm3+LDS_K+hi*1024+r32*16; const lds_cptr vp0=shm3+LDS_V+((lane>>4)&1)*32+(lane&3)*8+(4*hi+((lane&15)>>2))*64;
  DMA_K(0,0);DMA_V(0,0);DMA_K(1,SLOTB);
  bf16x8 qr[4];
  #pragma unroll
  for(int d0=0;d0<4;++d0)qr[d0]=*reinterpret_cast<const bf16x8*>(&Qw[(long)r32*QP+d0*16+hi*8]);
  float mhat=0.f,l_reg=0.f;f32x16 o[2];o[0]=f32x16{};o[1]=f32x16{};f32x16 negm=f32x16{};asm volatile("":"+v"(negm));
  #define CMASK(P0,P1,t) do{}while(0)
  bool resc=false;
  #define START(P0,P1) do{ const float rm=rowmax(P0,P1); resc=false; \
    { const float dl=rm; mhat=fadd_s(mhat,dl); \
      _Pragma("unroll") for(int r=0;r<16;++r){P0[r]=fsub_s(P0[r],dl);P1[r]=fsub_s(P1[r],dl);} \
      _Pragma("unroll") for(int r=0;r<16;++r)negm[r]=-mhat; asm volatile("":"+v"(negm)); } \
    _Pragma("unroll") for(int r=0;r<16;++r)P0[r]=__builtin_amdgcn_exp2f(P0[r]); }while(0)
  #define RESC() do{ if(resc){ asm volatile("s_waitcnt lgkmcnt(0)":::"memory"); \
      _Pragma("unroll") for(int d_=0;d_<2;++d_) _Pragma("unroll") for(int r=0;r<16;++r)o[d_][r]*=wsf[crow(r,hi)]; } }while(0)
  f32x16 pA0,pA1,pB0,pB1;
  int sl_prev=0,sl_cur=0,sl_next=SLOTB;
  #define ROT() do{sl_prev=sl_cur;sl_cur=sl_next;sl_next=(sl_next==(NSLOT-1)*SLOTB)?0:sl_next+SLOTB;}while(0)
  DMA_K(2,2*SLOTB);
  WAIT_BAR(3);
  qkt(pA0,pA1,Kbase,qr,negm,r32,hi);asm volatile("s_nop 15\n\ts_nop 7":"+v"(pA0),"+v"(pA1));CMASK(pA0,pA1,0);
  START(pA0,pA1);
  _Pragma("unroll") for(int r=0;r<16;++r)pA1[r]=__builtin_amdgcn_exp2f(pA1[r]);
  WAIT_BAR(0);
  DMA_K(3,0);DMA_V(1,SLOTB);
  ROT();
  kload8(kf,kp0+sl_cur);
  WAIT_BAR(2);
  s16x4 vlo[8],vhi[8]; u32x4 pw0,pw1,pw2,pw3;
  #define PKW(P,B) cvtpk_s(P[B],P[B+1])
  #define PAF(k) __builtin_bit_cast(bf16x8,pw##k)
  #define VFR(i) (bf16x8){vlo[i][0],vlo[i][1],vlo[i][2],vlo[i][3],vhi[i][0],vhi[i][1],vhi[i][2],vhi[i][3]}
  #define PIN(x) asm volatile("":"+v"(x))
  #define MX3(a,b,c) __builtin_fmaxf(__builtin_fmaxf((a),(b)),(c))
  #define GAPA(MF,A0,A1,A2,A3,W0,W1,PW) do{ MF; sacc+=A0; sacc+=A1; sacc+=A2; sacc+=A3; PIN(sacc); W0; W1; PIN(PW); SBAR(); }while(0)
  #define EX(v) __builtin_amdgcn_exp2f(v)
  #define GAPB(MF,X,B) do{ MF; X[B]=EX(X[B]); X[B+1]=EX(X[B+1]); X[B+2]=EX(X[B+2]); X[B+3]=EX(X[B+3]); PIN(X); SBAR(); }while(0)
  #define VRD(i) do{ vlo[i]=vtr(vp_+(((i)>>2)*4096+((i)&3)*1024)); vhi[i]=vtr(vp_+(((i)>>2)*4096+((i)&3)*1024+512)); }while(0)
  #define KRD(G,j) do{ if(G){ kload2(kf,kp0+sl_next,j); SBAR(); } }while(0)
  #define STEP(C0,C1,P0,P1,t,GK,GV,GL) do{ SBAR(); \
    const lds_cptr vp_=vp0+sl_prev; \
    VRD(0); SBAR(); float sacc=(P0[0]+P0[1]); \
    GAPA(C0=__builtin_amdgcn_mfma_f32_32x32x16_bf16(kf[0],qr[0],negm,0,0,0), P0[2],P0[3],P0[4],P0[5],     pw0[0]=PKW(P0,0), pw0[1]=PKW(P0,2), pw0); \
    VRD(4); SBAR(); GAPA(C1=__builtin_amdgcn_mfma_f32_32x32x16_bf16(kf[1],qr[0],negm,0,0,0), P0[6],P0[7],P0[8],P0[9],     pw0[2]=PKW(P0,4), pw0[3]=PKW(P0,6), pw0); \
    VRD(1); SBAR(); GAPA(C0=__builtin_amdgcn_mfma_f32_32x32x16_bf16(kf[2],qr[1],C0,0,0,0),   P0[10],P0[11],P0[12],P0[13], pw1[0]=PKW(P0,8), pw1[1]=PKW(P0,10), pw1); \
    VRD(5); SBAR(); GAPA(C1=__builtin_amdgcn_mfma_f32_32x32x16_bf16(kf[3],qr[1],C1,0,0,0),   P0[14],P0[15],P1[0],P1[1],   pw1[2]=PKW(P0,12),pw1[3]=PKW(P0,14), pw1); \
    VRD(2); SBAR(); GAPA(C0=__builtin_amdgcn_mfma_f32_32x32x16_bf16(kf[4],qr[2],C0,0,0,0),   P1[2],P1[3],P1[4],P1[5],     pw2[0]=PKW(P1,0), pw2[1]=PKW(P1,2), pw2); \
    VRD(6); SBAR(); GAPA(C1=__builtin_amdgcn_mfma_f32_32x32x16_bf16(kf[5],qr[2],C1,0,0,0),   P1[6],P1[7],P1[8],P1[9],     pw2[2]=PKW(P1,4), pw2[3]=PKW(P1,6), pw2); \
    VRD(3); SBAR(); GAPA(C0=__builtin_amdgcn_mfma_f32_32x32x16_bf16(kf[6],qr[3],C0,0,0,0),   P1[10],P1[11],P1[12],P1[13], pw3[0]=PKW(P1,8), pw3[1]=PKW(P1,10), pw3); \
    VRD(7); SBAR(); GAPA(C1=__builtin_amdgcn_mfma_f32_32x32x16_bf16(kf[7],qr[3],C1,0,0,0),   P1[14],P1[15],0.f,0.f,       pw3[2]=PKW(P1,12),pw3[3]=PKW(P1,14), pw3); \
    l_reg+=sacc; \
    if(GK){DMA_K((t)+3,sl_cur);} if(GV){DMA_V((t)+1,sl_next);} \
    CMASK(C0,C1,t); \
    { float a=MX3(C0[0],C0[1],C1[0]),b=MX3(C0[2],C0[3],C1[1]); a=MX3(a,C1[2],C1[3]); \
      _Pragma("unroll") for(int r=4;r<16;r+=4){a=MX3(a,C0[r],C0[r+1]);b=MX3(b,C0[r+2],C0[r+3]);a=MX3(a,C1[r],C1[r+1]);b=MX3(b,C1[r+2],C1[r+3]);} \
      float rm=__builtin_fmaxf(a,b); { auto rr=__builtin_amdgcn_permlane32_swap(__float_as_uint(rm),__float_as_uint(rm),false,false); rm=__builtin_fmaxf(__uint_as_float(rr[0]),__uint_as_float(rr[1])); } \
      resc=false; \
      if(__builtin_expect(__any(rm>(float)THRL),0)){ const float dl=__builtin_fmaxf(rm,0.f); mhat+=dl; \
        _Pragma("unroll") for(int r=0;r<16;++r){C0[r]-=dl;C1[r]-=dl;} \
        _Pragma("unroll") for(int r=0;r<16;++r)negm[r]=-mhat; asm volatile("":"+v"(negm)); \
        const float f=__builtin_amdgcn_exp2f(-dl); l_reg*=f; if(hi==0)wsf[r32]=f; resc=true; } } \
    SBAR(); \
    GAPB(o[0]=__builtin_amdgcn_mfma_f32_32x32x16_bf16(PAF(0),VFR(0),o[0],0,0,0), C0,0); \
    GAPB(o[1]=__builtin_amdgcn_mfma_f32_32x32x16_bf16(PAF(0),VFR(4),o[1],0,0,0), C0,4); \
    KRD(GL,0); GAPB(o[0]=__builtin_amdgcn_mfma_f32_32x32x16_bf16(PAF(1),VFR(1),o[0],0,0,0), C0,8); \
    KRD(GL,1); GAPB(o[1]=__builtin_amdgcn_mfma_f32_32x32x16_bf16(PAF(1),VFR(5),o[1],0,0,0), C0,12); \
    KRD(GL,2); GAPB(o[0]=__builtin_amdgcn_mfma_f32_32x32x16_bf16(PAF(2),VFR(2),o[0],0,0,0), C1,0); \
    KRD(GL,3); GAPB(o[1]=__builtin_amdgcn_mfma_f32_32x32x16_bf16(PAF(2),VFR(6),o[1],0,0,0), C1,4); \
    GAPB(o[0]=__builtin_amdgcn_mfma_f32_32x32x16_bf16(PAF(3),VFR(3),o[0],0,0,0), C1,8); \
    GAPB(o[1]=__builtin_amdgcn_mfma_f32_32x32x16_bf16(PAF(3),VFR(7),o[1],0,0,0), C1,12); \
    }while(0)
  int t=1;
  #undef CMASK
  #define CMASK(P0,P1,t) do{}while(0)
  for(;t+5<NT;t+=2){
    STEP(pB0,pB1,pA0,pA1,t,true,true,true);     WAIT_BAR(2); RESC(); ROT();
    STEP(pA0,pA1,pB0,pB1,t+1,true,true,true);   WAIT_BAR(2); RESC(); ROT();
  }
  #undef CMASK
  #define CMASK(P0,P1,t) do{}while(0)
  #define ENDW(tt) do{ if((tt)+3<NT){WAIT_BAR(2);} else if((tt)+2<NT){WAIT_BAR(1);} else {WAIT_BAR(0);} }while(0)
  for(;t+1<NT;t+=2){
    STEP(pB0,pB1,pA0,pA1,t,(t+3<NT),(t+1<NT),(t+1<NT));       ENDW(t);   RESC(); ROT();
    STEP(pA0,pA1,pB0,pB1,t+1,(t+4<NT),(t+2<NT),(t+2<NT));     ENDW(t+1); RESC(); ROT();
  }
  STEP(pB0,pB1,pA0,pA1,NT-1,false,false,false); RESC();
  { float sacc=pB0[0]+pB0[1]; _Pragma("unroll") for(int r=2;r<16;++r)sacc+=pB0[r]; _Pragma("unroll") for(int r=0;r<16;++r)sacc+=pB1[r]; l_reg+=sacc;
    pw0=(u32x4){PKW(pB0,0),PKW(pB0,2),PKW(pB0,4),PKW(pB0,6)};pw1=(u32x4){PKW(pB0,8),PKW(pB0,10),PKW(pB0,12),PKW(pB0,14)};pw2=(u32x4){PKW(pB1,0),PKW(pB1,2),PKW(pB1,4),PKW(pB1,6)};pw3=(u32x4){PKW(pB1,8),PKW(pB1,10),PKW(pB1,12),PKW(pB1,14)};
    SBAR(); pv(o,vb0+sl_cur,PAF(0),PAF(1),PAF(2),PAF(3)); }
  #undef PKW
  #undef PAF
  #undef VFR
  #undef PIN
  #undef MX3
  #undef GAPA
  #undef GAPB
  #undef EX
  #undef VRD
  #undef KRD
  #undef STEP
  #undef ENDW
  {auto rr=__builtin_amdgcn_permlane32_swap(__float_as_uint(l_reg),__float_as_uint(l_reg),false,false);l_reg=__uint_as_float(rr[0])+__uint_as_float(rr[1]);}
  if(hi==0)wsf[32+r32]=l_reg;asm volatile("s_waitcnt lgkmcnt(0)":::"memory");
  float rli[16];
  #pragma unroll
  for(int r=0;r<16;++r)rli[r]=__builtin_amdgcn_rcpf(wsf[32+crow(r,hi)]);
  bf16*Ow=O+(rowbase+q0+wid*QBLK)*QP+h*D;
  { bf16*stg=(bf16*)(shm+LDS_OST)+wid*2048;
    #pragma unroll
    for(int r=0;r<16;++r){const int orow=crow(r,hi);
      #pragma unroll
      for(int d0=0;d0<2;++d0)stg[orow*64+d0*32+r32]=__float2bfloat16(o[d0][r]*rli[r]);}
    asm volatile("s_waitcnt lgkmcnt(0)":::"memory");
    #pragma unroll
    for(int i=0;i<4;++i){const int row=i*8+(lane>>3),ch=lane&7; const u32x4 v=*(const u32x4*)(stg+row*64+ch*8); ATTN_STORE16(Ow+(long)row*QP+ch*8,v);} }
  asm volatile("s_waitcnt lgkmcnt(0)\n\ts_barrier":::"memory");
  #undef DMA_K
  #undef DMA_V
  #undef CMASK
  #undef START
  #undef RESC
  #undef ROT
}
constexpr int ATTN_LDS_BYTES=LDS_BYTES;
#undef SBAR
#undef WAIT_BAR
}


#ifndef MK_COOP
#define MK_COOP 0
#endif
constexpr int NWAVES = 8;
constexpr int T = 98304, TP = 65536;
constexpr int NPHASE = 15;
constexpr float ALPHA = 1.189207115002721f;
constexpr size_t MiB = 1u << 20;
constexpr size_t WS_WUP = 1 * MiB, WS_WDN = 9 * MiB, WS_XB = 17 * MiB  ;
constexpr size_t WS_R = 209 * MiB;
constexpr size_t WS_WIN = 209 * MiB, WS_WP = 215 * MiB, WS_WA = 217 * MiB, WS_WF = 218 * MiB, WS_WM = 219 * MiB, WS_WMQ = 221 * MiB, WS_WK = 223 * MiB, WS_WV = 225 * MiB, WS_WMO = 227 * MiB;
constexpr size_t WS_ROPE = 229 * MiB, WS_D1S = 230 * MiB, WS_D1P = 230 * MiB + 512 * 1024, WS_M2S = 231 * MiB, WS_M2P = 247 * MiB;
constexpr size_t WS_MB = 251 * MiB, WS_KM = 260 * MiB, WS_VT = 269 * MiB;
constexpr size_t WS_Q = 278 * MiB, WS_K = 374 * MiB, WS_V = 398 * MiB, WS_GA = 422 * MiB, WS_GF = 614 * MiB, WS_ZF = 806 * MiB, WS_END = 998 * MiB;
constexpr size_t WS_H = WS_R;
constexpr size_t WS_QM = WS_GF, WS_P = WS_ZF, WS_OM = WS_GA;
static_assert(WS_H + (size_t)T * 4096 * 2 <= WS_END, "h overlay");
constexpr int RING_OFF = 0, RING_BYTES = 131072, XCH_OFF = RING_BYTES + 1024, LDS_BYTES = 147456;

#define GAS __attribute__((address_space(1)))
#define LAS __attribute__((address_space(3)))
typedef unsigned short bf16;
typedef unsigned v4u __attribute__((ext_vector_type(4)));
typedef float f32x4 __attribute__((ext_vector_type(4)));
#define LDS_WAIT() asm volatile("s_waitcnt lgkmcnt(0)" ::: "memory")
__device__ __forceinline__ unsigned f2bf(float f) { unsigned u = __builtin_bit_cast(unsigned, f); return (u + 0x7fffu + ((u >> 16) & 1u)) >> 16; }
__device__ __forceinline__ unsigned pk2(float lo, float hi) { return f2bf(lo) | (f2bf(hi) << 16); }

__constant__ double FREQ_OVER_PI[16] = {
    0.3183098861837907, 0.17899880321778203, 0.10065842420897407, 0.0566043916612468, 0.03183098861837907, 0.017899880321778205, 0.010065842420897407, 0.00566043916612468,
    0.003183098861837907, 0.0017899880321778205, 0.0010065842420897407, 0.0005660439166124679, 0.0003183098861837907, 0.00017899880321778204, 0.00010065842420897407, 5.660439166124679e-05 };

__device__ __forceinline__ float wave_sum(float v) {
#pragma unroll
    for (int o = 1; o < 64; o <<= 1) v += __shfl_xor(v, o);
    return v;
}
__device__ __forceinline__ void p0_transpose_item(const float* W, int ldw, int K, bf16* WT, int dst_row0, int src_col0, int k0, LAS float* scr, int lane) {
#pragma unroll 8
    for (int i = 0; i < 32; ++i) { const int kk = 2 * i + (lane >> 5); scr[kk * 33 + (lane & 31)] = W[(size_t)(k0 + kk) * ldw + src_col0 + (lane & 31)]; }
    LDS_WAIT(); asm volatile("" ::: "memory");
    const int c = lane & 7;
#pragma unroll
    for (int j = 0; j < 4; ++j) { const int n = (lane >> 3) + 8 * j; const LAS float* s = scr + (8 * c) * 33 + n;
        v4u o; o.x = pk2(s[0 * 33], s[1 * 33]); o.y = pk2(s[2 * 33], s[3 * 33]); o.z = pk2(s[4 * 33], s[5 * 33]); o.w = pk2(s[6 * 33], s[7 * 33]);
        *(GAS v4u*)(WT + (size_t)(dst_row0 + n) * K + k0 + 8 * c) = o; }
    LDS_WAIT(); asm volatile("" ::: "memory");
}
__device__ __forceinline__ void ln_row(float* row, const float* g, const float* b, bf16* orow, int lane) {
    GAS f32x4* xr = (GAS f32x4*)row + lane; const GAS f32x4* g4 = (const GAS f32x4*)g + lane; const GAS f32x4* b4 = (const GAS f32x4*)b + lane;
    f32x4 v[4]; float s = 0.f;
#pragma unroll
    for (int j = 0; j < 4; ++j) { v[j] = xr[64 * j]; s += (v[j].x + v[j].y) + (v[j].z + v[j].w); }
    const float mean = wave_sum(s) * (1.f / 1024.f); float s2 = 0.f;
#pragma unroll
    for (int j = 0; j < 4; ++j) { v[j] = v[j] - mean; s2 += (v[j].x * v[j].x + v[j].y * v[j].y) + (v[j].z * v[j].z + v[j].w * v[j].w); }
    const float rstd = 1.f / sqrtf(wave_sum(s2) * (1.f / 1024.f) + 1e-5f);
#pragma unroll
    for (int j = 0; j < 4; ++j) { const f32x4 y = v[j] * rstd * g4[64 * j] + b4[64 * j]; xr[64 * j] = y;
        if (orow) { GAS unsigned long long* o8 = (GAS unsigned long long*)orow + lane; o8[64 * j] = (unsigned long long)pk2(y.x, y.y) | ((unsigned long long)pk2(y.z, y.w) << 32); } }
}

struct Args { const float* in[22]; float* out; unsigned char* ws; int ph_lo, ph_hi, coop, pad; };

__global__ void __launch_bounds__(NWAVES * 64, 2) mega_fwd(Args args) {
    extern __shared__ __attribute__((aligned(16))) unsigned char lds[];
    LAS unsigned char* L = (LAS unsigned char*)lds;
    LAS unsigned char* XL = L + XCH_OFF;
    const int tid = threadIdx.x, lane = tid & 63, wave = __builtin_amdgcn_readfirstlane(tid >> 6);
    const int G = gridDim.x, bx = blockIdx.x;
    const int vcu = (G % 8 == 0) ? (bx % 8) * (G / 8) + bx / 8 : bx;
    unsigned char* ws = args.ws;
    const float* x_p = args.in[0]; const float* x_s = args.in[1]; float* out = args.out;
    bf16* WupT = (bf16*)(ws + WS_WUP); bf16* WdnT = (bf16*)(ws + WS_WDN); bf16* XB = (bf16*)(ws + WS_XB);
    bf16* WinT = (bf16*)(ws + WS_WIN); bf16* WpT = (bf16*)(ws + WS_WP); bf16* WaT = (bf16*)(ws + WS_WA); bf16* WfT = (bf16*)(ws + WS_WF); bf16* WmT = (bf16*)(ws + WS_WM);
    bf16* WmqT = (bf16*)(ws + WS_WMQ); bf16* WkT = (bf16*)(ws + WS_WK); bf16* WvT = (bf16*)(ws + WS_WV); bf16* WmoT = (bf16*)(ws + WS_WMO);
    float* ROPE = (float*)(ws + WS_ROPE); bf16* D1S = (bf16*)(ws + WS_D1S); bf16* D1P = (bf16*)(ws + WS_D1P); bf16* M2S = (bf16*)(ws + WS_M2S); bf16* M2P = (bf16*)(ws + WS_M2P);
    bf16* MB = (bf16*)(ws + WS_MB); bf16* KM = (bf16*)(ws + WS_KM); bf16* VT = (bf16*)(ws + WS_VT);
    bf16* QB_ = (bf16*)(ws + WS_Q); bf16* KB_ = (bf16*)(ws + WS_K); bf16* VB_ = (bf16*)(ws + WS_V); bf16* GA = (bf16*)(ws + WS_GA); bf16* GF = (bf16*)(ws + WS_GF);
    bf16* Zp = (bf16*)(ws + WS_ZF); bf16* Zs = Zp + (size_t)16 * 512 * 4096 * 2; bf16* FB = (bf16*)(ws + WS_ZF);
    bf16* Yp = XB; bf16* Ys = Yp + (size_t)16 * 512 * 4096 * 2;
    bf16* QM = (bf16*)(ws + WS_QM); bf16* PB = (bf16*)(ws + WS_P); bf16* OM = (bf16*)(ws + WS_OM); bf16* HB = (bf16*)(ws + WS_H);

    const int lo = args.ph_lo, hi = args.ph_hi;
#define IN(k) (lo <= (k) && (k) < hi)
#define SEAM(k) do { if (IN(k) && IN((k) + 1)) { cg::this_grid().sync(); } } while (0)
    const int gw = vcu * NWAVES + wave, NGW = G * NWAVES;
    const size_t gtid = (size_t)vcu * (NWAVES * 64) + tid, NTH = (size_t)G * (NWAVES * 64);

    if (IN(0)) {
        LAS float* ctab = (LAS float*)XL; LAS float* stab = ctab + 128;
        if (tid < 128) { ctab[tid] = cospif((float)tid * (1.0f / 64.0f)); stab[tid] = sinpif((float)tid * (1.0f / 64.0f)); }
        __syncthreads();
        LAS float* scr = (LAS float*)(L + wave * 16384);
        constexpr int NIT = 16 * 88 + 8 * 32 * 2 + 16 * 32 * 5 + 16 * 128 + 64 * 32;
        for (int it = gw; it < NIT; it += NGW) {
            int r = it;
#define XP(W, ldw, Kd, Nd, WT, MODE) { const int nblk = (Nd) / 32, items = ((Kd) / 64) * nblk; if (r < items) { const int kb = r / nblk, nb = r % nblk; int sc = 32 * nb; \
                if (MODE) { const int pos0 = 32 * nb, rc = 256 * (pos0 >> 8) + 64 * ((pos0 >> 5) & 3) + 32 * ((pos0 >> 7) & 1); sc = rc < 768 ? rc : rc + 512; } \
                p0_transpose_item(W, ldw, Kd, WT, 32 * nb, sc, 64 * kb, scr, lane); continue; } r -= items; }
            XP(args.in[4], 3328, 1024, 2816, WinT, 1)
            XP(args.in[7], 1024, 512, 1024, WaT, 0)
            XP(args.in[8], 1024, 512, 1024, WfT, 0)
            XP(args.in[9], 1024, 1024, 1024, WmT, 0)
            XP(args.in[12], 1024, 1024, 1024, WmqT, 0)
            XP(args.in[13], 1024, 1024, 1024, WkT, 0)
            XP(args.in[14], 1024, 1024, 1024, WvT, 0)
            XP(args.in[15], 1024, 1024, 1024, WmoT, 0)
            XP(args.in[18], 4096, 1024, 4096, WupT, 0)
            XP(args.in[19], 1024, 4096, 1024, WdnT, 0)
#undef XP
        }
        for (int it = gw; it < 8192; it += NGW) {
            const int k = it >> 3, g = (it >> 1) & 3, cp = (it & 1) * 64 + lane;
            const float* wr_ = args.in[4] + (size_t)k * 3328 + 768 + g * 128;
            float ac = 0.f, as = 0.f;
#pragma unroll 8
            for (int c = 0; c < 128; ++c) { const float w = wr_[c]; const int ix = (c * cp) & 127; ac += w * ctab[ix]; as += w * stab[ix]; }
            WpT[(size_t)(g * 128 + cp) * 1024 + k] = (bf16)f2bf(ac); WpT[(size_t)(512 + g * 128 + cp) * 1024 + k] = (bf16)f2bf(-as);
        }
        for (size_t e = gtid; e < 5120; e += NTH) { const int p = (int)(e >> 4), i = (int)(e & 15); const int pos = p < 256 ? p : p - 256;
            double xx = (double)pos * FREQ_OVER_PI[i]; xx -= 2.0 * rint(xx * 0.5); const float xf = (float)xx; ROPE[2 * e] = cospif(xf); ROPE[2 * e + 1] = sinpif(xf); }
        for (size_t e = gtid; e < 65536; e += NTH) { const int row = (int)(e >> 8), ck = (int)(e & 255);
            { const int q = row >> 7, k1 = row & 127, p = ck >> 7, s1 = ck & 127; const float a = (float)((k1 * s1) & 127) * (1.0f / 64.0f); const float c = cospif(a), sn = sinpif(a);
              D1S[e] = (bf16)f2bf(q == p ? c : (q == 0 ? sn : -sn)); }
            { const int s2l = row >> 7, q = (row >> 6) & 1, k1 = row & 63, s2m = ck >> 7, p = (ck >> 6) & 1, s1 = ck & 63; const float a = (float)((k1 * s1) & 63) * (1.0f / 32.0f); const float c = cospif(a), sn = sinpif(a);
              D1P[e] = (bf16)f2bf(s2l != s2m ? 0.f : (q == p ? c : (q == 0 ? sn : -sn))); } }
        for (size_t e = gtid; e < (size_t)64 * 256 * 512; e += NTH) { const int g = (int)(e >> 17), row = (int)(e >> 9) & 255, ck = (int)e & 511;
            const int k1l = row >> 7, k2 = row & 127, k1m = ck >> 8, q = (ck >> 7) & 1, s2 = ck & 127; const int k = 2 * g + k1l + 128 * k2;
            const float a = (float)((s2 * k) & 16383) * (1.0f / 8192.0f); const float v = (q == 0 ? cospif(a) : sinpif(a)) * 6.905339660024878e-4f;
            M2S[e] = (bf16)f2bf(k1l == k1m ? v : 0.f); }
        for (size_t e = gtid; e < (size_t)16 * 256 * 512; e += NTH) { const int g = (int)(e >> 17), row = (int)(e >> 9) & 255, ck = (int)e & 511;
            const int k1l = row >> 6, k2 = row & 63, k1m = ck >> 7, q = (ck >> 6) & 1, sp = ck & 63, s2 = 2 * (sp & 31) + (sp >> 5); const int k = 4 * g + k1l + 64 * k2;
            const float a = (float)((s2 * k) & 4095) * (1.0f / 2048.0f); const float v = (q == 0 ? cospif(a) : sinpif(a)) * 1.3810679320049757e-3f;
            M2P[e] = (bf16)f2bf(k1l == k1m ? v : 0.f); }
        for (size_t e = gtid; e < (size_t)T * 128; e += NTH) { const float* src = e < (size_t)TP * 128 ? x_p + e * 8 : x_s + (e - (size_t)TP * 128) * 8;
            const f32x4 a = *(const GAS f32x4*)src, b = *(const GAS f32x4*)(src + 4); v4u o; o.x = pk2(a.x, a.y); o.y = pk2(a.z, a.w); o.z = pk2(b.x, b.y); o.w = pk2(b.z, b.w); *(GAS v4u*)(XB + e * 8) = o; }
        for (size_t e = gtid; e < (size_t)4608 * 128; e += NTH) { const float* src = e < (size_t)4096 * 128 ? args.in[2] + e * 8 : args.in[3] + (e - (size_t)4096 * 128) * 8;
            const f32x4 a = *(const GAS f32x4*)src, b = *(const GAS f32x4*)(src + 4); v4u o; o.x = pk2(a.x, a.y); o.y = pk2(a.z, a.w); o.z = pk2(b.x, b.y); o.w = pk2(b.z, b.w); *(GAS v4u*)(MB + e * 8) = o; }
        __syncthreads();
    }
    SEAM(0);
    if (IN(1)) {
        { pg8::Gemm g = pg8::mk_gemm(1024, 2048, 2048); pg8::SchedG S = pg8::sched_std(XB, 2048, 384, WinT, 2048, 11, G, bx);
          pg8::EpiIn E{QB_, KB_, VB_, GA, GF, args.in[5], args.in[6], ROPE}; pg8::gemm_phase<pg8::EpiIn, pg8::SchedG, true, true>(L, XL, g, S, E); }
        { pg8::Gemm g = pg8::mk_gemm(1024, 2048, 2048); g.bm1 = 64; g.bs1 = 64; g.bs2 = 1; g.hstepB = 2 * 2048;
          pg8::SchedG S; S.o.init(4, 256, G, bx); S.A = (const char*)WpT; S.B = (const char*)XB; S.aPm = (size_t)256 * 2048; S.aInner = 0; S.bPm = 0; S.div = 16; S.bOuter = (size_t)4096 * 2048; S.bInner = 4 * 2048; S.bBatch = 0;
          pg8::EpiZ E{Zp, 6, 16}; pg8::gemm_phase<pg8::EpiZ, pg8::SchedG, true, true>(L, XL, g, S, E); }
        { pg8::Gemm g = pg8::mk_gemm(1024, 2048, 2048); g.bm1 = 128; g.bs1 = 128; g.bs2 = 0; g.hstepB = 2048;
          pg8::SchedG S; S.o.init(4, 128, G, bx); S.A = (const char*)WpT; S.B = (const char*)(XB + (size_t)TP * 1024); S.aPm = (size_t)256 * 2048; S.aInner = 0; S.bPm = 0; S.div = 64; S.bOuter = (size_t)16384 * 2048; S.bInner = 2 * 2048; S.bBatch = 0;
          pg8::EpiZ E{Zs, 7, 64}; pg8::gemm_phase<pg8::EpiZ, pg8::SchedG, true, true>(L, XL, g, S, E); }
        { pg8::Gemm g = pg8::mk_gemm(1024, 2048, 2048); pg8::SchedG S = pg8::sched_std(MB, 2048, 18, WkT, 2048, 4, G, bx);
          pg8::EpiBf16<0> E{KM, 1024, 1.f}; pg8::gemm_phase<pg8::EpiBf16<0>, pg8::SchedG, true, true>(L, XL, g, S, E); }
        { pg8::Gemm g = pg8::mk_gemm(1024, 2048, 2048); pg8::SchedG S = pg8::sched_std(WvT, 2048, 4, MB, 2048, 18, G, (bx + 72) % G);
          pg8::EpiBf16<0> E{VT, 4608, 1.f}; pg8::gemm_phase<pg8::EpiBf16<0>, pg8::SchedG, true, true>(L, XL, g, S, E); }
    }
    SEAM(1);
    if (IN(2)) {
        const attn_body::bf16* Qa = (const attn_body::bf16*)QB_; const attn_body::bf16* Ka = (const attn_body::bf16*)KB_; const attn_body::bf16* Va = (const attn_body::bf16*)VB_;
        if (G == 256) {
            const int xcd = vcu >> 5, l = vcu & 31;
            for (int i = 0; i < 12; ++i) {
                if (i < 4) { const int combo = xcd >> 1, b = combo >> 1, kvh = combo & 1, ui = ((xcd & 1) * 32 + l) * 4 + i;
                    attn_body::attn_unit<8>((long)TP + (long)b * 16384, kvh * 4 + (ui >> 6), ui & 63, 256, Qa, Ka, Va, (attn_body::bf16*)QB_, (char*)lds + RING_OFF); }
                else { const int combo = 4 * xcd + (l >> 3), b = combo >> 1, kvh = combo & 1, ix = (l & 7) * 8 + (i - 4);
                    attn_body::attn_unit<8>((long)b * 4096, kvh * 4 + (ix >> 4), ix & 15, 64, Qa, Ka, Va, (attn_body::bf16*)QB_, (char*)lds + RING_OFF); }
            }
        } else {
            for (int Lu = bx; Lu < 3072; Lu += G) {
                if (Lu < 1024) attn_body::attn_unit<8>((long)TP + (long)(Lu >> 9) * 16384, (Lu >> 6) & 7, Lu & 63, 256, Qa, Ka, Va, (attn_body::bf16*)QB_, (char*)lds + RING_OFF);
                else { const int Lp = Lu - 1024; attn_body::attn_unit<8>((long)(Lp >> 7) * 4096, (Lp >> 4) & 7, Lp & 15, 64, Qa, Ka, Va, (attn_body::bf16*)QB_, (char*)lds + RING_OFF); }
            }
        }
        asm volatile("s_waitcnt vmcnt(0) lgkmcnt(0)" ::: "memory"); __syncthreads();
        { pg8::Gemm g = pg8::mk_gemm(256, 512, 512); pg8::SchedG S = pg8::sched_std(D1P, 512, 1, Zp, 512, 1024, G, bx);
          pg8::EpiY E{Yp, 0}; pg8::gemm_phase<pg8::EpiY, pg8::SchedG, true, true>(L, XL, g, S, E); }
        { pg8::Gemm g = pg8::mk_gemm(256, 512, 512); pg8::SchedG S = pg8::sched_std(D1S, 512, 1, Zs, 512, 512, G, bx);
          pg8::EpiY E{Ys, 1}; pg8::gemm_phase<pg8::EpiY, pg8::SchedG, true, true>(L, XL, g, S, E); }
    }
    SEAM(2);
    if (IN(3)) {
        { pg8::Gemm g = pg8::mk_gemm(512, 1024, 65536);
          pg8::SchedG S; S.o.init(64, 4, G, bx); S.A = (const char*)M2S; S.B = (const char*)Ys; S.aPm = 262144; S.aInner = 0; S.bPm = 1024; S.div = 2; S.bOuter = (size_t)512 * 65536; S.bInner = (size_t)256 * 65536; S.bBatch = 0;
          pg8::EpiF E{FB, 1}; pg8::gemm_phase<pg8::EpiF, pg8::SchedG, true, true>(L, XL, g, S, E); }
        { pg8::Gemm g = pg8::mk_gemm(512, 1024, 16384);
          pg8::SchedG S; S.o.init(16, 32, G, bx); S.A = (const char*)M2P; S.B = (const char*)Yp; S.aPm = 262144; S.aInner = 0; S.bPm = 1024; S.div = 2; S.bOuter = (size_t)512 * 16384; S.bInner = (size_t)256 * 16384; S.bBatch = 0;
          pg8::EpiF E{FB, 0}; pg8::gemm_phase<pg8::EpiF, pg8::SchedG, true, true>(L, XL, g, S, E); }
    }
    SEAM(3);
    if (IN(4)) {
        { pg8::Gemm g = pg8::mk_gemm(512, 1024, 1024); pg8::SchedG S = pg8::sched_std(QB_, 1024, 384, WaT, 1024, 4, G, bx);
          pg8::EpiGate<0> E{GA, GF}; pg8::gemm_phase<pg8::EpiGate<0>, pg8::SchedG, true, true>(L, XL, g, S, E); }
        { pg8::Gemm g = pg8::mk_gemm(512, 1024, 1024); pg8::SchedG S = pg8::sched_std(FB, 1024, 384, WfT, 1024, 4, G, bx);
          pg8::EpiGate<1> E{GA, GF}; pg8::gemm_phase<pg8::EpiGate<1>, pg8::SchedG, true, true>(L, XL, g, S, E); }
    }
    SEAM(4);
    if (IN(5)) {
        pg8::Gemm g = pg8::mk_gemm(1024, 2048, 2048); pg8::SchedG S = pg8::sched_std(GA, 2048, 384, WmT, 2048, 4, G, bx);
        pg8::EpiRes E{x_p, x_s - (size_t)TP * 1024, out, ALPHA}; pg8::gemm_phase<pg8::EpiRes, pg8::SchedG, true, true>(L, XL, g, S, E);
    }
    SEAM(5);
    if (IN(6)) { for (int m = gw; m < T; m += NGW) ln_row(out + (size_t)m * 1024, args.in[10], args.in[11], XB + (size_t)m * 1024, lane); }
    SEAM(6);
    if (IN(7)) {
        pg8::Gemm g = pg8::mk_gemm(1024, 2048, 2048); pg8::SchedG S = pg8::sched_std(XB, 2048, 384, WmqT, 2048, 4, G, bx);
        pg8::EpiBf16<0> E{QM, 1024, 0.0625f * 1.4426950408889634f}; pg8::gemm_phase<pg8::EpiBf16<0>, pg8::SchedG, true, true>(L, XL, g, S, E);
    }
    SEAM(7);
    if (IN(8)) {
        pg8::Gemm g = pg8::mk_gemm(256, 2048, 2048);
        pg8::SchedG S; S.o.init(384, 4, G, bx); S.A = (const char*)QM; S.B = (const char*)KM; S.aPm = (size_t)256 * 2048; S.aInner = 512; S.bPm = 0; S.div = 1 << 30; S.bOuter = 0; S.bInner = 512; S.bBatch = (size_t)256 * 2048;
        pg8::EpiSoftmax E{PB}; pg8::gemm_phase<pg8::EpiSoftmax, pg8::SchedG, true, true>(L, XL, g, S, E);
    }
    SEAM(8);
    if (IN(9)) {
        pg8::Gemm g = pg8::mk_gemm(256, 2048, 9216);
        pg8::SchedG S; S.o.init(384, 4, G, bx); S.A = (const char*)PB; S.B = (const char*)VT; S.aPm = (size_t)256 * 2048; S.aInner = 512; S.bPm = 0; S.div = 1 << 30; S.bOuter = 0; S.bInner = (size_t)256 * 9216; S.bBatch = 512;
        pg8::EpiBf16<0> E{OM, 1024, 1.f}; pg8::gemm_phase<pg8::EpiBf16<0>, pg8::SchedG, true, true>(L, XL, g, S, E);
    }
    SEAM(9);
    if (IN(10)) {
        pg8::Gemm g = pg8::mk_gemm(1024, 2048, 2048); pg8::SchedG S = pg8::sched_std(OM, 2048, 384, WmoT, 2048, 4, G, bx);
        pg8::EpiRes E{out, out, out, ALPHA}; pg8::gemm_phase<pg8::EpiRes, pg8::SchedG, true, true>(L, XL, g, S, E);
    }
    SEAM(10);
    if (IN(11)) { for (int m = gw; m < T; m += NGW) ln_row(out + (size_t)m * 1024, args.in[16], args.in[17], XB + (size_t)m * 1024, lane); }
    SEAM(11);
    if (IN(12)) {
        pg8::Gemm g = pg8::mk_gemm(1024, 2048, 2048); pg8::SchedG S = pg8::sched_std(XB, 2048, 384, WupT, 2048, 16, G, bx);
        pg8::EpiBf16<2> E{HB, 4096, 1.f}; pg8::gemm_phase<pg8::EpiBf16<2>, pg8::SchedG, true, true>(L, XL, g, S, E);
    }
    SEAM(12);
    if (IN(13)) {
        pg8::Gemm g = pg8::mk_gemm(4096, 8192, 8192); pg8::SchedG S = pg8::sched_std(HB, 8192, 384, WdnT, 8192, 4, G, bx);
        pg8::EpiRes E{out, out, out, ALPHA}; pg8::gemm_phase<pg8::EpiRes, pg8::SchedG, true, true>(L, XL, g, S, E);
    }
    SEAM(13);
    if (IN(14)) { for (int m = gw; m < T; m += NGW) ln_row(out + (size_t)m * 1024, args.in[20], args.in[21], (bf16*)nullptr, lane); }
#undef IN
#undef SEAM
}

extern "C" void kernel_launch(void* const* d_in, const int* in_sizes, int n_in, void* d_out, int out_size, void* d_ws, size_t ws_size, hipStream_t stream) {
    static int grid = 0;
    if (grid == 0) {
        if (n_in != 22 || out_size != T * 1024 || ws_size < WS_END) { fprintf(stderr, "kernel_launch: unexpected sizes: n_in %d out %d ws %zu (need %zu)\n", n_in, out_size, ws_size, (size_t)WS_END); grid = -1; return; }
        int dev = 0, cus = 0, per_cu = 0;
        hipGetDevice(&dev); hipDeviceGetAttribute(&cus, hipDeviceAttributeMultiprocessorCount, dev);
        if (hipFuncSetAttribute((const void*)mega_fwd, hipFuncAttributeMaxDynamicSharedMemorySize, LDS_BYTES) != hipSuccess) { fprintf(stderr, "kernel_launch: hipFuncSetAttribute failed\n"); grid = -1; return; }
        if (hipOccupancyMaxActiveBlocksPerMultiprocessor(&per_cu, (const void*)mega_fwd, NWAVES * 64, LDS_BYTES) != hipSuccess || per_cu < 1) { fprintf(stderr, "kernel_launch: occupancy query says %d\n", per_cu); per_cu = 1; }
        (void)hipGetLastError();
        grid = cus * 1;
    }
    if (grid < 0) return;
    Args a{};
    for (int i = 0; i < 22; ++i) a.in[i] = (const float*)d_in[i];
    a.out = (float*)d_out; a.ws = (unsigned char*)d_ws;
#if MK_COOP
    a.ph_lo = 0; a.ph_hi = NPHASE; a.coop = 1;
    void* kargs[] = {&a};
    hipError_t e = hipLaunchCooperativeKernel((const void*)mega_fwd, dim3(grid), dim3(NWAVES * 64), kargs, LDS_BYTES, stream);
    if (e != hipSuccess) fprintf(stderr, "kernel_launch: cooperative launch failed: %s (grid %d)\n", hipGetErrorString(e), grid);
#else
    for (int ph = 0; ph < NPHASE; ++ph) { a.ph_lo = ph; a.ph_hi = ph + 1; a.coop = 0; hipLaunchKernelGGL(mega_fwd, dim3(grid), dim3(NWAVES * 64), LDS_BYTES, stream, a); }
#endif
}
```
